# Optimizing an MI355X kernel written in HIP

```python
import math
import jax, jax.numpy as jnp
from jax import lax
import numpy as np

D_MODEL = 1024
BATCH = 2
SEQ = 8192
DEPTH = 2

N_MIXERS = 2
EPS = 1e-6

A_EXPAND = 2
A_WIDTH = A_EXPAND * D_MODEL
A_CHUNK = 128
A_HEADS = 16
A_HEAD_DIM = A_WIDTH // A_HEADS

B_GROUPS = ((128, 1), (512, 4), (2048, 16))
B_N_GROUPS = len(B_GROUPS)
B_HEADS = 16
B_HEAD_DIM = 64
B_WIDTH = B_HEADS * B_HEAD_DIM
B_QKV = B_N_GROUPS * 3 * B_WIDTH
B_TOTAL_HEADS = B_N_GROUPS * B_HEADS

REL_BUCKETS = 32
REL_EXACT = 8
REL_MAX_DISTANCE = 1024

N_A_LAYERS = (DEPTH + 1) // 2
N_B_LAYERS = DEPTH // 2
NEG_INF = -1e30

kernel_name = "hybrid_gmlp_dilated_attn_encoder"


def rms_norm(x, g):
    xf = x.astype(jnp.float32)
    y = xf * lax.rsqrt(jnp.mean(xf * xf, axis=-1, keepdims=True) + EPS)
    return (y * g.astype(jnp.float32)).astype(x.dtype)


def layer_norm(x, g, b):
    xf = x.astype(jnp.float32)
    mu = jnp.mean(xf, axis=-1, keepdims=True)
    xc = xf - mu
    y = xc * lax.rsqrt(jnp.mean(xc * xc, axis=-1, keepdims=True) + EPS)
    return (y * g.astype(jnp.float32) + b.astype(jnp.float32)).astype(x.dtype)


def t5_bucket(rel):
    half = REL_BUCKETS // 2
    ret = jnp.where(rel > 0, half, 0)
    n = jnp.abs(rel)
    nf = jnp.maximum(n, 1).astype(jnp.float32)
    large = REL_EXACT + (jnp.log(nf / REL_EXACT) / math.log(REL_MAX_DISTANCE / REL_EXACT)
                         * (half - REL_EXACT)).astype(jnp.int32)
    large = jnp.minimum(large, half - 1)
    return ret + jnp.where(n < REL_EXACT, n, large)


def gmlp_mixer(h, w_in, w_s, b_s, vn_g, vn_b, w_out):
    bsz, s, _ = h.shape
    z = h @ w_in
    u, v, g = jnp.split(z, 3, axis=-1)
    u = jax.nn.gelu(u)
    v = layer_norm(jax.nn.gelu(v), vn_g, vn_b)
    nc = s // A_CHUNK
    vc = v.reshape(bsz, nc, A_CHUNK, A_HEADS, A_HEAD_DIM)
    sg = jnp.einsum('hpq,bcqhd->bcphd', w_s, vc) + b_s.T[None, None, :, :, None]
    y = u * sg.reshape(bsz, s, A_WIDTH) * jax.nn.silu(g)
    return y @ w_out


def dilated_window_group(q, k, v, table, dilation, half_w):
    bsz, s, nh, dh = q.shape
    L = s // dilation
    W = half_w
    nb = -(-L // W)
    Lp = nb * W

    def strided(t):
        return t.reshape(bsz, L, dilation, nh, dh).transpose(0, 2, 1, 3, 4)

    qs = jnp.pad(strided(q), ((0, 0), (0, 0), (0, Lp - L), (0, 0), (0, 0)))
    pad_kv = ((0, 0), (0, 0), (W, Lp - L + W), (0, 0), (0, 0))
    kp = jnp.pad(strided(k), pad_kv).reshape(bsz, dilation, nb + 2, W, nh, dh)
    vp = jnp.pad(strided(v), pad_kv).reshape(bsz, dilation, nb + 2, W, nh, dh)

    def band(t):
        return jnp.concatenate([t[:, :, 0:nb], t[:, :, 1:nb + 1], t[:, :, 2:nb + 2]], axis=3)

    kb, vb = band(kp), band(vp)
    qb = qs.reshape(bsz, dilation, nb, W, nh, dh)

    logits = jnp.einsum('bnkqhd,bnkjhd->bnkhqj', qb, kb,
                        preferred_element_type=jnp.float32) * (dh ** -0.5)
    qi = jnp.arange(W, dtype=jnp.int32)[:, None]
    kj = jnp.arange(3 * W, dtype=jnp.int32)[None, :]
    rel = kj - W - qi
    bias = table.astype(jnp.float32)[t5_bucket(rel * dilation)].transpose(2, 0, 1)
    key_pos = jnp.arange(nb, dtype=jnp.int32)[:, None] * W + kj - W
    mask = (jnp.abs(rel) <= W)[None] & ((key_pos >= 0) & (key_pos < L))[:, None, :]
    logits = jnp.where(mask[None, None, :, None], logits + bias, NEG_INF)

    m = jnp.max(logits, axis=-1, keepdims=True)
    p = jnp.exp(logits - m)
    den = jnp.sum(p, axis=-1, keepdims=True)
    o = jnp.einsum('bnkhqj,bnkjhd->bnkqhd', p / den, vb.astype(jnp.float32))
    lse = (m + jnp.log(den))[..., 0]

    o = o.reshape(bsz, dilation, Lp, nh, dh)[:, :, :L].transpose(0, 2, 1, 3, 4).reshape(bsz, s, nh, dh)
    lse = lse.transpose(0, 1, 2, 4, 3).reshape(bsz, dilation, Lp, nh)[:, :, :L]
    lse = lse.transpose(0, 2, 1, 3).reshape(bsz, s, nh)
    return o, lse


def dilated_attention_mixer(h, w_in, w_out, rel_table):
    bsz, s, _ = h.shape
    z = h @ w_in
    qkv = z[..., :B_QKV].reshape(bsz, s, B_N_GROUPS, 3, B_HEADS, B_HEAD_DIM)
    gate = z[..., B_QKV:]
    outs, lses = [], []
    for gi, (window, dil) in enumerate(B_GROUPS):
        o, lse = dilated_window_group(qkv[:, :, gi, 0], qkv[:, :, gi, 1], qkv[:, :, gi, 2],
                                      rel_table[:, gi * B_HEADS:(gi + 1) * B_HEADS],
                                      dil, window // (2 * dil))
        outs.append(o)
        lses.append(lse)
    wts = jax.nn.softmax(jnp.stack(lses), axis=0)
    o = jnp.einsum('gbsh,gbshd->bshd', wts, jnp.stack(outs))
    y = o.reshape(bsz, s, B_WIDTH).astype(h.dtype) * jax.nn.silu(gate)
    return y @ w_out


def setup_inputs(seed: int = 0) -> dict:
    key = jax.random.key(seed)
    ks = jax.random.split(key, 16)
    f32 = jnp.float32
    x = jax.random.normal(ks[0], (BATCH, SEQ, D_MODEL), f32)
    norm_pre = 1.0 + 0.1 * jax.random.normal(ks[1], (DEPTH, D_MODEL), f32)
    norm_post = 1.0 + 0.1 * jax.random.normal(ks[2], (DEPTH, D_MODEL), f32)
    a_w_in = jax.random.normal(ks[3], (N_A_LAYERS, D_MODEL, 3 * A_WIDTH), f32) * D_MODEL ** -0.5
    a_w_s = jax.random.normal(ks[4], (N_A_LAYERS, A_HEADS, A_CHUNK, A_CHUNK), f32) * A_CHUNK ** -0.5
    a_b_s = 1.0 + 0.1 * jax.random.normal(ks[5], (N_A_LAYERS, A_HEADS, A_CHUNK), f32)
    a_vnorm_g = 1.0 + 0.1 * jax.random.normal(ks[6], (N_A_LAYERS, A_WIDTH), f32)
    a_vnorm_b = 0.1 * jax.random.normal(ks[7], (N_A_LAYERS, A_WIDTH), f32)
    a_w_out = jax.random.normal(ks[8], (N_A_LAYERS, A_WIDTH, D_MODEL), f32) * A_WIDTH ** -0.5
    b_w_in = jax.random.normal(ks[9], (N_B_LAYERS, D_MODEL, B_QKV + B_WIDTH), f32) * D_MODEL ** -0.5
    b_w_out = jax.random.normal(ks[10], (N_B_LAYERS, B_WIDTH, D_MODEL), f32) * B_WIDTH ** -0.5
    rel_bias = 0.5 * jax.random.normal(ks[11], (REL_BUCKETS, B_TOTAL_HEADS), f32)
    return {"x": x, "norm_pre": norm_pre, "norm_post": norm_post,
            "a_w_in": a_w_in, "a_w_s": a_w_s, "a_b_s": a_b_s,
            "a_vnorm_g": a_vnorm_g, "a_vnorm_b": a_vnorm_b, "a_w_out": a_w_out,
            "b_w_in": b_w_in, "b_w_out": b_w_out, "rel_bias": rel_bias}


def reference(x, norm_pre, norm_post, a_w_in, a_w_s, a_b_s, a_vnorm_g, a_vnorm_b, a_w_out,
              b_w_in, b_w_out, rel_bias):
    for i in range(DEPTH):
        h = rms_norm(x, norm_pre[i])
        j = i // N_MIXERS
        if i % N_MIXERS == 0:
            y = gmlp_mixer(h, a_w_in[j], a_w_s[j], a_b_s[j], a_vnorm_g[j], a_vnorm_b[j], a_w_out[j])
        else:
            y = dilated_attention_mixer(h, b_w_in[j], b_w_out[j], rel_bias)
        x = x + rms_norm(y, norm_post[i])
    return x
```

```cpp
#include <hip/hip_runtime.h>
#include <cstdio>
#include <cstdint>
namespace pg8 {
#define PG8_LAS __attribute__((address_space(3)))
typedef unsigned short bf16_t;
typedef short bf16x8 __attribute__((ext_vector_type(8)));
typedef float f32x4 __attribute__((ext_vector_type(4)));
typedef unsigned u32x4 __attribute__((ext_vector_type(4)));
constexpr int BM = 256, BK = 64, HALF = 128, HTB = HALF * BK * 2  , STAGE_BYTES = 8 * HTB, NXCD = 8, WGM = 8;

__host__ __device__ __forceinline__ int lds_byte(int r, int c) { const int st = (r >> 4) * 2 + (c >> 5), rr = r & 15, cc = c & 31, ob = rr * 64 + cc * 2; return st * 1024 + (ob ^ (((ob >> 9) & 1) << 5)); }
__host__ __device__ __forceinline__ void stage_rc(int b, int& R, int& C) { const int st = b / 1024, sb = b % 1024, swz = sb ^ (((sb >> 9) & 1) << 5); R = (st >> 1) * 16 + swz / 64; C = (st & 1) * 32 + (swz % 64) / 2; }
__host__ __device__ __forceinline__ int perm32(int rho) { const int n = rho >> 4, i = rho & 15; return 8 * (i >> 2) + 4 * n + (i & 3); }

struct Unit { int pm, pn; };
struct Gemm { const bf16_t* A; const bf16_t* Bt; int M, N, K; };

struct StaticOrder {
    int nM, nN, nwg, G, c;
    __host__ __device__ void init(int M, int N, int G_, int c_) { nM = M / BM; nN = N / BM; nwg = nM * nN; G = G_; c = c_; }
    __host__ __device__ bool next(int i, Unit& u) const {
        const long L = (long)i * G + c; if (L >= nwg) return false;
        int wgid = (int)L; { const int q = nwg / NXCD, r = nwg % NXCD, xcd = wgid % NXCD, off = wgid / NXCD; wgid = (xcd < r ? xcd * (q + 1) : r * (q + 1) + (xcd - r) * q) + off; }
        const int nig = WGM * nN, gid = wgid / nig, fm = gid * WGM, gsz = (nM - fm) < WGM ? (nM - fm) : WGM;
        u.pm = fm + ((wgid % nig) % gsz); u.pn = (wgid % nig) / gsz; return true;
    }
    __device__ __forceinline__ void a_ready(const Unit&) const {}
    __device__ __forceinline__ void done(const Unit&) const {}
};


__device__ __forceinline__ unsigned cvt_pk_bf16(float lo, float hi) { unsigned r; asm volatile("v_cvt_pk_bf16_f32 %0, %1, %2" : "=v"(r) : "v"(lo), "v"(hi)); return r; }
__device__ __forceinline__ float gelu_tanh(float x) { const float t = x * (1.0f + 0.044715f * x * x); return x * __builtin_amdgcn_rcpf(1.0f + __builtin_amdgcn_exp2f(-2.302208198f * t)); }
__device__ __forceinline__ float silu_f(float x) { return x * __builtin_amdgcn_rcpf(1.0f + __builtin_amdgcn_exp2f(-1.4426950409f * x)); }

struct EpiBf16 {
    static constexpr bool PERM = true, AFTER_DRAIN = false;
    bf16_t* O; int ldc;
    __device__ __forceinline__ void operator()(const f32x4 (&acc)[2][2][4][2], const Unit& u, int wr, int wc, int fr, int fq) const {
        const int row0 = u.pm * BM + wr * 64 + fr, col0 = u.pn * BM + wc * 32 + 8 * fq;
#pragma unroll
        for (int ai = 0; ai < 2; ++ai)
#pragma unroll
            for (int m = 0; m < 4; ++m) { bf16_t* rowp = O + (size_t)(row0 + ai * HALF + m * 16) * ldc + col0;
#pragma unroll
                for (int bj = 0; bj < 2; ++bj) { const f32x4 v0 = acc[ai][bj][m][0], v1 = acc[ai][bj][m][1];
                    u32x4 w; w.x = cvt_pk_bf16(v0[0], v0[1]); w.y = cvt_pk_bf16(v0[2], v0[3]); w.z = cvt_pk_bf16(v1[0], v1[1]); w.w = cvt_pk_bf16(v1[2], v1[3]);
                    *(u32x4*)(rowp + bj * HALF) = w; } }
    }
};
struct EpiF32 {
    static constexpr bool PERM = false, AFTER_DRAIN = false;
    float* O; int ldc;
    __device__ __forceinline__ void operator()(const f32x4 (&acc)[2][2][4][2], const Unit& u, int wr, int wc, int fr, int fq) const {
        const int row0 = u.pm * BM + wr * 64 + fr, col0 = u.pn * BM + wc * 32 + 4 * fq;
#pragma unroll
        for (int ai = 0; ai < 2; ++ai)
#pragma unroll
            for (int m = 0; m < 4; ++m) { float* rowp = O + (size_t)(row0 + ai * HALF + m * 16) * ldc + col0;
#pragma unroll
                for (int bj = 0; bj < 2; ++bj)
#pragma unroll
                    for (int n = 0; n < 2; ++n) *(f32x4*)(rowp + bj * HALF + n * 16) = acc[ai][bj][m][n]; }
    }
};
struct EpiA1 {
    static constexpr bool PERM = true, AFTER_DRAIN = false;
    bf16_t* UG; bf16_t* GV; float* VST;
    __device__ __forceinline__ void operator()(const f32x4 (&acc)[2][2][4][2], const Unit& u, int wr, int wc, int fr, int fq) const {
        const int row0 = u.pm * BM + wr * 64 + fr;
        if (u.pn < 16) {
            const int col0 = u.pn * 128 + wc * 32 + 8 * fq;
#pragma unroll
            for (int ai = 0; ai < 2; ++ai)
#pragma unroll
                for (int m = 0; m < 4; ++m) { bf16_t* rowp = UG + (size_t)(row0 + ai * HALF + m * 16) * 2048 + col0;
                    float y[8];
#pragma unroll
                    for (int n = 0; n < 2; ++n)
#pragma unroll
                        for (int j = 0; j < 4; ++j) y[n * 4 + j] = gelu_tanh(acc[ai][0][m][n][j]) * silu_f(acc[ai][1][m][n][j]);
                    u32x4 w; w.x = cvt_pk_bf16(y[0], y[1]); w.y = cvt_pk_bf16(y[2], y[3]); w.z = cvt_pk_bf16(y[4], y[5]); w.w = cvt_pk_bf16(y[6], y[7]);
                    *(u32x4*)rowp = w; }
        } else {
            const int vt = u.pn - 16, col0 = vt * 256 + wc * 32 + 8 * fq;
#pragma unroll
            for (int ai = 0; ai < 2; ++ai)
#pragma unroll
                for (int m = 0; m < 4; ++m) { const int row = row0 + ai * HALF + m * 16; bf16_t* rowp = GV + (size_t)row * 2048 + col0;
                    float s = 0.f, ss = 0.f;
#pragma unroll
                    for (int bj = 0; bj < 2; ++bj) { float y[8];
#pragma unroll
                        for (int n = 0; n < 2; ++n)
#pragma unroll
                            for (int j = 0; j < 4; ++j) { const float g = gelu_tanh(acc[ai][bj][m][n][j]); y[n * 4 + j] = g; s += g; ss += g * g; }
                        u32x4 w; w.x = cvt_pk_bf16(y[0], y[1]); w.y = cvt_pk_bf16(y[2], y[3]); w.z = cvt_pk_bf16(y[4], y[5]); w.w = cvt_pk_bf16(y[6], y[7]);
                        *(u32x4*)(rowp + bj * HALF) = w; }
                    s += __shfl_xor(s, 16); s += __shfl_xor(s, 32); ss += __shfl_xor(ss, 16); ss += __shfl_xor(ss, 32);
                    if (fq == 0) { typedef float f32x2v __attribute__((ext_vector_type(2))); *(f32x2v*)(VST + ((size_t)(row * 8 + vt) * 4 + wc) * 2) = (f32x2v){s, ss}; } }
        }
    }
};

template <class Epi, class Sched, bool ALIGN_EPI = false, bool SP2 = false>
__device__ __forceinline__ void gemm_phase(PG8_LAS unsigned char* lds, const Gemm g, const Sched& S, const Epi& E) {
    const int tid = threadIdx.x, wid = __builtin_amdgcn_readfirstlane(tid >> 6), lane = tid & 63, wr = wid >> 2, wc = wid & 3, fr = lane & 15, fq = lane >> 4;
    const int K = g.K, nt = K / BK;
    unsigned voffA[2], voffB[2];
#pragma unroll
    for (int i = 0; i < 2; ++i) { int R, C; stage_rc(tid * 16 + i * 8192, R, C); const int Rb = Epi::PERM ? ((R & ~31) + perm32(R & 31)) : R;
        voffA[i] = (unsigned)(R * K + C) * 2u; voffB[i] = (unsigned)(Rb * K + C) * 2u; }
    const size_t kstep = (size_t)(BK * 2);
    const size_t hstep = (size_t)HALF * K * 2;
    const size_t tstep = 2 * hstep;
    const unsigned ldsw = (unsigned)wid * 1024u;
    const int aoff = lds_byte(wr * 64 + fr, fq * 8), boff = lds_byte(wc * 32 + fr, fq * 8);
#define PG8_SA(b, h) (((b) * 2 + (h)) * HTB)
#define PG8_SB(b, h) ((4 + (b) * 2 + (h)) * HTB)
#define PG8_STAGE(bufoff, gbase, voff) do { _Pragma("unroll") for (int _i = 0; _i < 2; ++_i) \
        __builtin_amdgcn_global_load_lds((const unsigned*)((const char*)(gbase) + (voff)[_i]), (PG8_LAS unsigned*)(lds + (bufoff) + ldsw + _i * 8192), 16, 0, 0); } while (0)
#define PG8_LDA(dst, b, h) do { _Pragma("unroll") for (int m = 0; m < 4; ++m) _Pragma("unroll") for (int k = 0; k < 2; ++k) dst[m][k] = *(const PG8_LAS bf16x8*)(lds + PG8_SA(b, h) + aoff + m * 2048 + k * 1024); } while (0)
#define PG8_LDB(dst, b, h) do { _Pragma("unroll") for (int n = 0; n < 2; ++n) _Pragma("unroll") for (int k = 0; k < 2; ++k) dst[n][k] = *(const PG8_LAS bf16x8*)(lds + PG8_SB(b, h) + boff + n * 2048 + k * 1024); } while (0)
#define PG8_MMA(ai, bj, At, Bt) do { __builtin_amdgcn_s_setprio(1); _Pragma("unroll") for (int m = 0; m < 4; ++m) _Pragma("unroll") for (int n = 0; n < 2; ++n) _Pragma("unroll") for (int k = 0; k < 2; ++k) \
        acc[ai][bj][m][n] = __builtin_amdgcn_mfma_f32_16x16x32_bf16(Bt[n][k], At[m][k], acc[ai][bj][m][n], 0, 0, 0); __builtin_amdgcn_s_setprio(0); } while (0)
#define PG8_WAIT_V(n) asm volatile("s_waitcnt vmcnt(" #n ")" ::: "memory")
#define PG8_WAIT_L(n) asm volatile("s_waitcnt lgkmcnt(" #n ")" ::: "memory")
#define PG8_BAR __builtin_amdgcn_s_barrier()
#define PG8_SCHED __builtin_amdgcn_sched_barrier(0)
    Unit cur, nxt; int ui = 0;
    if (!S.next(0, cur)) return;
    f32x4 acc[2][2][4][2];
#pragma unroll
    for (int a = 0; a < 2; ++a)
#pragma unroll
        for (int b = 0; b < 2; ++b)
#pragma unroll
            for (int m = 0; m < 4; ++m)
#pragma unroll
                for (int n = 0; n < 2; ++n) acc[a][b][m][n] = (f32x4){0.f, 0.f, 0.f, 0.f};
    bf16x8 At[4][2], B0[2][2], B1[2][2];
    const char* cA = (const char*)g.A + (size_t)cur.pm * tstep; const char* cB = (const char*)g.Bt + (size_t)cur.pn * tstep;
    S.a_ready(cur);
    if constexpr (SP2) {
        PG8_STAGE(PG8_SB(0, 0), cB, voffB); PG8_STAGE(PG8_SB(0, 1), cB + hstep, voffB); PG8_STAGE(PG8_SA(0, 0), cA, voffA); PG8_STAGE(PG8_SA(0, 1), cA + hstep, voffA);
        if (wr == 1) PG8_BAR;
        PG8_WAIT_V(2); PG8_BAR;
        PG8_STAGE(PG8_SB(1, 0), cB + kstep, voffB); PG8_STAGE(PG8_SA(1, 0), cA + kstep, voffA); PG8_STAGE(PG8_SB(1, 1), cB + hstep + kstep, voffB);
        PG8_WAIT_V(6); PG8_BAR;
    } else {
        PG8_STAGE(PG8_SB(0, 0), cB, voffB); PG8_STAGE(PG8_SA(0, 0), cA, voffA); PG8_STAGE(PG8_SB(0, 1), cB + hstep, voffB); PG8_STAGE(PG8_SA(0, 1), cA + hstep, voffA);
        if (wr == 1) PG8_BAR;
        PG8_WAIT_V(4); PG8_BAR;
        PG8_STAGE(PG8_SB(1, 0), cB + kstep, voffB); PG8_STAGE(PG8_SA(1, 0), cA + kstep, voffA); PG8_STAGE(PG8_SB(1, 1), cB + hstep + kstep, voffB);
        PG8_WAIT_V(6); PG8_BAR;
    }
    for (;;) {
        const bool has_next = S.next(ui + 1, nxt);
        const char* nA = has_next ? (const char*)g.A + (size_t)nxt.pm * tstep : cA; const char* nB = has_next ? (const char*)g.Bt + (size_t)nxt.pn * tstep : cB;
        for (int t = 0; t < nt; t += 2) {
            const bool last = (t == nt - 2);
            const char* a1 = cA + (size_t)(t + 1) * kstep;
            const char* a2 = last ? nA : cA + (size_t)(t + 2) * kstep; const char* b2 = last ? nB : cB + (size_t)(t + 2) * kstep;
            const char* a3 = a2 + kstep; const char* b3 = b2 + kstep;
            if (last && has_next) S.a_ready(nxt);
            if constexpr (SP2) {
            PG8_LDB(B0, 0, 0); PG8_LDB(B1, 0, 1); PG8_SCHED; PG8_LDA(At, 0, 0); PG8_STAGE(PG8_SA(1, 1), a1 + hstep, voffA);
            PG8_WAIT_V(8); PG8_WAIT_L(0); PG8_BAR; PG8_MMA(0, 0, At, B0); PG8_MMA(0, 1, At, B1); PG8_BAR; PG8_SCHED;
            PG8_LDA(At, 0, 1); PG8_STAGE(PG8_SB(0, 0), b2, voffB); PG8_STAGE(PG8_SB(0, 1), b2 + hstep, voffB); PG8_STAGE(PG8_SA(0, 0), a2, voffA);
            PG8_WAIT_V(8); PG8_WAIT_L(0); PG8_BAR; PG8_MMA(1, 0, At, B0); PG8_MMA(1, 1, At, B1); PG8_BAR; PG8_SCHED;
            PG8_LDB(B0, 1, 0); PG8_LDB(B1, 1, 1); PG8_SCHED; PG8_LDA(At, 1, 0); PG8_STAGE(PG8_SA(0, 1), a2 + hstep, voffA);
            PG8_WAIT_V(8); PG8_WAIT_L(0); PG8_BAR; PG8_MMA(0, 0, At, B0); PG8_MMA(0, 1, At, B1); PG8_BAR; PG8_SCHED;
            PG8_LDA(At, 1, 1); PG8_STAGE(PG8_SB(1, 0), b3, voffB); PG8_STAGE(PG8_SB(1, 1), b3 + hstep, voffB); PG8_STAGE(PG8_SA(1, 0), a3, voffA);
            PG8_WAIT_V(8); PG8_WAIT_L(0); PG8_BAR; PG8_MMA(1, 0, At, B0); PG8_MMA(1, 1, At, B1); PG8_BAR; PG8_SCHED;
            } else {
            PG8_LDB(B0, 0, 0); PG8_SCHED; PG8_LDA(At, 0, 0); PG8_STAGE(PG8_SA(1, 1), a1 + hstep, voffA);
            PG8_WAIT_L(8); PG8_BAR; PG8_WAIT_L(0); PG8_MMA(0, 0, At, B0); PG8_BAR; PG8_SCHED;
            PG8_LDB(B1, 0, 1); PG8_STAGE(PG8_SB(0, 0), b2, voffB);
            PG8_BAR; PG8_WAIT_L(0); PG8_MMA(0, 1, At, B1); PG8_BAR;
            PG8_LDA(At, 0, 1); PG8_STAGE(PG8_SA(0, 0), a2, voffA);
            PG8_BAR; PG8_WAIT_L(0); PG8_MMA(1, 0, At, B0); PG8_BAR; PG8_SCHED;
            PG8_STAGE(PG8_SB(0, 1), b2 + hstep, voffB);
            PG8_WAIT_V(6); PG8_BAR; PG8_MMA(1, 1, At, B1); PG8_BAR;
            PG8_LDB(B0, 1, 0); PG8_SCHED; PG8_LDA(At, 1, 0); PG8_STAGE(PG8_SA(0, 1), a2 + hstep, voffA);
            PG8_WAIT_L(8); PG8_BAR; PG8_WAIT_L(0); PG8_MMA(0, 0, At, B0); PG8_BAR; PG8_SCHED;
            PG8_LDB(B1, 1, 1); PG8_STAGE(PG8_SB(1, 0), b3, voffB);
            PG8_BAR; PG8_WAIT_L(0); PG8_MMA(0, 1, At, B1); PG8_BAR;
            PG8_LDA(At, 1, 1); PG8_STAGE(PG8_SA(1, 0), a3, voffA);
            PG8_BAR; PG8_WAIT_L(0); PG8_MMA(1, 0, At, B0); PG8_BAR; PG8_SCHED;
            PG8_STAGE(PG8_SB(1, 1), b3 + hstep, voffB);
            PG8_WAIT_V(6); PG8_BAR; PG8_MMA(1, 1, At, B1); PG8_BAR;
            }
        }
        if constexpr (ALIGN_EPI) { if (wr == 0) PG8_BAR; }
        if constexpr (!Epi::AFTER_DRAIN) { E(acc, cur, wr, wc, fr, fq); S.done(cur); }
        if (!has_next) break;
#pragma unroll
        for (int a = 0; a < 2; ++a)
#pragma unroll
            for (int b = 0; b < 2; ++b)
#pragma unroll
                for (int m = 0; m < 4; ++m)
#pragma unroll
                    for (int n = 0; n < 2; ++n) acc[a][b][m][n] = (f32x4){0.f, 0.f, 0.f, 0.f};
        cur = nxt; cA = nA; cB = nB; ++ui;
        if constexpr (ALIGN_EPI) { if (wr == 1) PG8_BAR; }
    }
    PG8_WAIT_V(0);
    if constexpr (!ALIGN_EPI) { if (wr == 0) PG8_BAR; }
    PG8_BAR;
    if constexpr (Epi::AFTER_DRAIN) { E.fused(acc, cur, wr, wc, fr, fq, lds, wid, lane); S.done(cur); }
#undef PG8_SA
#undef PG8_SB
#undef PG8_STAGE
#undef PG8_LDA
#undef PG8_LDB
#undef PG8_MMA
#undef PG8_WAIT_V
#undef PG8_WAIT_L
#undef PG8_BAR
#undef PG8_SCHED
}
}

#ifndef MK_N_LAUNCHES
#define MK_N_LAUNCHES 13
#endif
constexpr int NWAVES = 8;
constexpr int N_PHASES = 13;
constexpr int SEQ = 8192, NB = 2, DM = 1024, M = NB * SEQ;
constexpr int AW = 2048;
constexpr int NQKVG = 10240;
constexpr float EPS = 1e-6f;
constexpr float LOG2E = 1.4426950408889634f;
constexpr float QSCALE = 0.125f * LOG2E;

constexpr size_t MiB = 1u << 20;
constexpr size_t WS_CTL = 0, CTL_ZERO_BYTES = 1 * MiB;
constexpr size_t WS_WS = 1 * MiB;
constexpr size_t WS_WA1 = 2 * MiB, WS_WA2 = 14 * MiB, WS_WB1 = 18 * MiB, WS_WB2 = 38 * MiB;
constexpr size_t WS_XB = 40 * MiB;
constexpr size_t WS_VST = 72 * MiB;
constexpr size_t WS_BIG = 80 * MiB;
constexpr size_t WS_GV = WS_BIG + 64 * MiB;
constexpr size_t WS_END = 256 * MiB;
static_assert(WS_BIG + (size_t)SEQ * NQKVG * 2 <= WS_END, "d_ws map");
constexpr int CW_BAR = 4096;

constexpr int RING_BYTES = 137216;
constexpr int LDSCTL_OFF = RING_BYTES, MISC_OFF = LDSCTL_OFF + 320;
constexpr int LDS_BYTES = 147456;

#define GAS __attribute__((address_space(1)))
#define LAS __attribute__((address_space(3)))
typedef unsigned short bf16;
typedef unsigned v4u __attribute__((ext_vector_type(4)));
typedef unsigned v2u __attribute__((ext_vector_type(2)));
typedef float f32x4 __attribute__((ext_vector_type(4)));
typedef float f32x2 __attribute__((ext_vector_type(2)));
typedef float f32x16 __attribute__((ext_vector_type(16)));
typedef short bf16x8 __attribute__((ext_vector_type(8)));
typedef short s16x4 __attribute__((ext_vector_type(4)));
typedef GAS unsigned gu32;
#define LDS_WAIT() asm volatile("s_waitcnt lgkmcnt(0)" ::: "memory")
#define VM_WAIT() asm volatile("s_waitcnt vmcnt(0)" ::: "memory")
__device__ __forceinline__ unsigned f2bf(float f) { unsigned u = __builtin_bit_cast(unsigned, f); return (u + 0x7fffu + ((u >> 16) & 1u)) >> 16; }
__device__ __forceinline__ unsigned pk2(float lo, float hi) { return f2bf(lo) | (f2bf(hi) << 16); }
__device__ __forceinline__ float bf_lo(unsigned w) { return __builtin_bit_cast(float, w << 16); }
__device__ __forceinline__ float bf_hi(unsigned w) { return __builtin_bit_cast(float, w & 0xffff0000u); }
__device__ __forceinline__ int crow(int r, int hi) { return (r & 3) + 8 * (r >> 2) + 4 * hi; }

#define XB_TMO      128
#define XB_XCNT(j)  (256  + 64 * (j))
#define XB_XSUB(j)  (1280 + 64 * (j))
#define XB_XGEN(j)  (2304 + 64 * (j))
#define XB_TOP      3328
#define XB_TOPGEN   3392
#define XCD_BAR_WORDS 3456
#define XB_SPIN_CAP (1u << 18)
__device__ __forceinline__ unsigned xb_ld(unsigned* p)              { return __hip_atomic_load(p, __ATOMIC_RELAXED, __HIP_MEMORY_SCOPE_AGENT); }
__device__ __forceinline__ unsigned xb_add(unsigned* p, unsigned v) { return __hip_atomic_fetch_add(p, v, __ATOMIC_RELAXED, __HIP_MEMORY_SCOPE_AGENT); }
__device__ __forceinline__ unsigned xb_xcc_id() { return (unsigned)__builtin_amdgcn_s_getreg((3 << 11) | 20) & 0xFu; }
#define XB_SPIN(cond, bar) do { unsigned _sp = 0; while (cond) { __builtin_amdgcn_s_sleep(1); \
    if ((++_sp & 255u) == 0u) { if (xb_ld(&(bar)[XB_TMO])) break; if (_sp > XB_SPIN_CAP) { atomicAdd(&(bar)[XB_TMO], 1u); break; } } } } while (0)
struct XcdBarrier { unsigned* bar; unsigned x; volatile LAS unsigned* st; };
__device__ __forceinline__ XcdBarrier xcd_barrier_post(unsigned* bar, volatile LAS unsigned* st) {
    XcdBarrier b; b.bar = bar; b.x = xb_xcc_id(); b.st = st;
    if (threadIdx.x == 0) (void)xb_add(&bar[XB_XCNT(b.x)], 1u);
    return b;
}
__device__ __forceinline__ void xcd_barrier_complete(unsigned* bar, unsigned x, unsigned& nloc, unsigned& nx) {
    const unsigned G = gridDim.x * gridDim.y * gridDim.z;
    unsigned sum, cnt, mine, sp = 0u;
    for (;;) {
        sum = 0u; cnt = 0u; mine = 0u;
#pragma unroll
        for (unsigned j = 0; j < 16; ++j) { const unsigned c = xb_ld(&bar[XB_XCNT(j)]); sum += c; cnt += (c > 0u) ? 1u : 0u; mine = (j == x) ? c : mine; }
        if (sum == G) break;
        __builtin_amdgcn_s_sleep(1);
        if ((++sp & 255u) == 0u) { if (xb_ld(&bar[XB_TMO])) break; if (sp > XB_SPIN_CAP) { atomicAdd(&bar[XB_TMO], 1u); break; } }
    }
    nloc = mine > 0u ? mine : 1u; nx = cnt > 0u ? cnt : 1u;
}
__device__ __forceinline__ void xcd_barrier(const XcdBarrier& b) {
    asm volatile("s_waitcnt vmcnt(0)" ::: "memory");
    __syncthreads();
    if (threadIdx.x == 0) {
        unsigned* bar = b.bar;
        __builtin_amdgcn_s_waitcnt(0);
        unsigned nloc = b.st[0], nx = b.st[1];
        if (nloc == 0u) { xcd_barrier_complete(bar, b.x, nloc, nx); b.st[0] = nloc; b.st[1] = nx; }
        const unsigned old = xb_add(&bar[XB_XSUB(b.x)], 1u);
        const unsigned gen = old / nloc;
        if (old + 1u == (gen + 1u) * nloc) {
            __builtin_amdgcn_fence(__ATOMIC_RELEASE, "agent");
            asm volatile("s_waitcnt vmcnt(0)" ::: "memory");
            const unsigned og = xb_add(&bar[XB_TOP], 1u);
            const unsigned tg = og / nx;
            if (og + 1u == (tg + 1u) * nx) xb_add(&bar[XB_TOPGEN], 1u);
            else XB_SPIN(xb_ld(&bar[XB_TOPGEN]) == tg, bar);
            __builtin_amdgcn_fence(__ATOMIC_ACQUIRE, "agent");
            xb_add(&bar[XB_XGEN(b.x)], 1u);
            asm volatile("s_waitcnt vmcnt(0)" ::: "memory");
        } else {
            XB_SPIN(xb_ld(&bar[XB_XGEN(b.x)]) == gen, bar);
            __builtin_amdgcn_fence(__ATOMIC_ACQUIRE, "agent");
            asm volatile("s_waitcnt vmcnt(0)" ::: "memory");
        }
    }
    __syncthreads();
}

struct Frame {
    LAS unsigned char* lds;
    int tid, lane, wave;
    int vcu, G;
};
struct Args { const float* in[12]; float* out; unsigned char* ws; int ph_lo, ph_hi; };
#define T_X        (A.in[0])
#define T_NPRE     (A.in[1])
#define T_NPOST    (A.in[2])
#define T_AWIN     (A.in[3])
#define T_AWS      (A.in[4])
#define T_ABS      (A.in[5])
#define T_AVNG     (A.in[6])
#define T_AVNB     (A.in[7])
#define T_AWOUT    (A.in[8])
#define T_BWIN     (A.in[9])
#define T_BWOUT    (A.in[10])
#define T_RELB     (A.in[11])
#define T_OUT      (A.out)
#define T_WSB      ((bf16*)(A.ws + WS_WS))
#define T_WA1      ((bf16*)(A.ws + WS_WA1))
#define T_WA2      ((bf16*)(A.ws + WS_WA2))
#define T_WB1      ((bf16*)(A.ws + WS_WB1))
#define T_WB2      ((bf16*)(A.ws + WS_WB2))
#define T_XB       ((bf16*)(A.ws + WS_XB))
#define T_UG       ((bf16*)(A.ws + WS_BIG))
#define T_GV       ((bf16*)(A.ws + WS_GV))
#define T_QKVG     ((bf16*)(A.ws + WS_BIG))
#define T_VST      ((float*)(A.ws + WS_VST))
#define T_LSE      ((float*)(A.ws + WS_VST))
#define T_OUT2     ((float*)(A.ws + WS_BIG))
__device__ __forceinline__ float wave_sum(float v) {
#pragma unroll
    for (int o = 1; o < 64; o <<= 1) v += __shfl_xor(v, o);
    return v;
}

__device__ __forceinline__ void p0_transpose_item(const float* W, int K, int N, bf16* WT, int k0, int n0, int drow0, const float* kscale, float cscale, LAS float* scr, int lane) {
#pragma unroll 8
    for (int i = 0; i < 32; ++i) { const int kk = 2 * i + (lane >> 5); const float sc = kscale ? kscale[k0 + kk] * cscale : cscale;
        scr[kk * 33 + (lane & 31)] = W[(size_t)(k0 + kk) * N + n0 + (lane & 31)] * sc; }
    LDS_WAIT(); asm volatile("" ::: "memory");
    const int c = lane & 7;
#pragma unroll
    for (int j = 0; j < 4; ++j) { const int n = (lane >> 3) + 8 * j; const LAS float* s = scr + (8 * c) * 33 + n;
        v4u o; o.x = pk2(s[0 * 33], s[1 * 33]); o.y = pk2(s[2 * 33], s[3 * 33]); o.z = pk2(s[4 * 33], s[5 * 33]); o.w = pk2(s[6 * 33], s[7 * 33]);
        *(GAS v4u*)(WT + (size_t)(drow0 + n) * K + k0 + 8 * c) = o; }
    LDS_WAIT(); asm volatile("" ::: "memory");
}
__device__ __forceinline__ void rms_row_to_bf16(const float* xrow, bf16* orow, int lane) {
    const GAS f32x4* xr = (const GAS f32x4*)xrow + lane;
    f32x4 v[4]; float s = 0.f;
#pragma unroll
    for (int j = 0; j < 4; ++j) { v[j] = xr[64 * j]; s += (v[j].x * v[j].x + v[j].y * v[j].y) + (v[j].z * v[j].z + v[j].w * v[j].w); }
    const float rstd = 1.0f / sqrtf(wave_sum(s) * (1.f / DM) + EPS);
    GAS v2u* o8 = (GAS v2u*)orow + lane;
#pragma unroll
    for (int j = 0; j < 4; ++j) { v2u w; w.x = pk2(v[j].x * rstd, v[j].y * rstd); w.y = pk2(v[j].z * rstd, v[j].w * rstd); o8[64 * j] = w; }
}
__device__ __forceinline__ void p0_prologue(Frame& F, const Args& A) {
    LAS float* scr = (LAS float*)(F.lds + F.wave * 16384);
    const int gw = F.vcu * NWAVES + F.wave, NGW = F.G * NWAVES;
    constexpr int I_A1 = (DM / 64) * (3 * AW / 32), I_A2 = (AW / 64) * (DM / 32), I_B1 = (DM / 64) * (NQKVG / 32), I_B2 = (DM / 64) * (DM / 32);
    constexpr int NITEMS = I_A1 + I_A2 + I_B1 + I_B2;
    for (int it = gw; it < NITEMS; it += NGW) {
        int r = it;
        if (r < I_A1) { const int nblk = 3 * AW / 32, kb = r / nblk, nb = r % nblk, n0 = 32 * nb; const int region = n0 / AW, c0 = n0 % AW;
            const int drow0 = region == 1 ? 4096 + c0 : 256 * (c0 / 128) + (c0 % 128) + (region == 2 ? 128 : 0);
            p0_transpose_item(T_AWIN, DM, 3 * AW, T_WA1, 64 * kb, n0, drow0, T_NPRE, 1.0f, scr, F.lane); continue; }
        r -= I_A1;
        if (r < I_A2) { const int nblk = DM / 32, kb = r / nblk, nb = r % nblk; p0_transpose_item(T_AWOUT, AW, DM, T_WA2, 64 * kb, 32 * nb, 32 * nb, nullptr, 1.0f, scr, F.lane); continue; }
        r -= I_A2;
        if (r < I_B1) { const int nblk = NQKVG / 32, kb = r / nblk, nb = r % nblk, n0 = 32 * nb; const bool isq = n0 < 9216 && (n0 % 3072) < 1024;
            p0_transpose_item(T_BWIN, DM, NQKVG, T_WB1, 64 * kb, n0, n0, T_NPRE + DM, isq ? QSCALE : 1.0f, scr, F.lane); continue; }
        r -= I_B1;
        { const int nblk = DM / 32, kb = r / nblk, nb = r % nblk; p0_transpose_item(T_BWOUT, DM, DM, T_WB2, 64 * kb, 32 * nb, 32 * nb, nullptr, 1.0f, scr, F.lane); }
    }
    for (int i = (F.vcu * NWAVES * 64 + F.tid); i < 16 * 128 * 128 / 4; i += F.G * NWAVES * 64) {
        const f32x4 v = ((const GAS f32x4*)T_AWS)[i]; v2u w; w.x = pk2(v.x, v.y); w.y = pk2(v.z, v.w); ((GAS v2u*)T_WSB)[i] = w; }
    for (int m = gw; m < M; m += NGW) rms_row_to_bf16(T_X + (size_t)m * DM, T_XB + (size_t)m * DM, F.lane);
}

__device__ __forceinline__ s16x4 vtr(const LAS unsigned char* p) { typedef short v4i16_t __attribute__((ext_vector_type(4)));
    return __builtin_bit_cast(s16x4, __builtin_amdgcn_ds_read_tr16_b64_v4i16((LAS v4i16_t*)p)); }
__device__ __forceinline__ void spatial_phase(Frame& F, const Args& A) {
    constexpr int ST_OFF = 0, VI_OFF = 1024, SG_OFF = 1024 + 32768, SGS = 132;
    LAS f32x2* stats = (LAS f32x2*)(F.lds + ST_OFF);
    LAS unsigned char* vimg = F.lds + VI_OFF;
    LAS float* sg = (LAS float*)(F.lds + SG_OFF);
    const int tid = F.tid, lane = F.lane, wave = F.wave, r32 = lane & 31, hi = lane >> 5;
    const int wp = wave & 3, wd = wave >> 2;
    const int vp_nat = (8 * hi + ((lane & 15) >> 2)) * 64 + ((lane >> 4) & 1) * 32 + (lane & 3) * 8;
    for (int item = F.vcu; item < 256; item += F.G) {
        const int cg = item >> 1, hh = item & 1, tok0 = cg * 128;
        { const int row = tid >> 2, q = tid & 3; const GAS f32x2* p = (const GAS f32x2*)T_VST + (size_t)(tok0 + row) * 32 + q * 8;
          float s = 0.f, ss = 0.f;
#pragma unroll
          for (int i = 0; i < 8; ++i) { const f32x2 v = p[i]; s += v.x; ss += v.y; }
          s += __shfl_xor(s, 1); s += __shfl_xor(s, 2); ss += __shfl_xor(ss, 1); ss += __shfl_xor(ss, 2);
          const float mean = s * (1.f / AW), var = ss * (1.f / AW) - mean * mean;
          if (q == 0) stats[row] = (f32x2){mean, 1.0f / sqrtf(var + EPS)}; }
        __syncthreads();
        for (int h8 = 0; h8 < 8; ++h8) {
            const int h = hh * 8 + h8, cb = h * 128, chunk = tid & 15;
            { const f32x4 g0 = *(const GAS f32x4*)(T_AVNG + cb + chunk * 8), g1 = *(const GAS f32x4*)(T_AVNG + cb + chunk * 8 + 4);
              const f32x4 b0 = *(const GAS f32x4*)(T_AVNB + cb + chunk * 8), b1 = *(const GAS f32x4*)(T_AVNB + cb + chunk * 8 + 4);
#pragma unroll
              for (int i = 0; i < 4; ++i) { const int row = (tid >> 4) + 32 * i;
                  const v4u raw = *(const GAS v4u*)(T_GV + (size_t)(tok0 + row) * AW + cb + chunk * 8);
                  const f32x2 st = stats[row];
                  v4u o;
                  o.x = pk2((bf_lo(raw.x) - st.x) * st.y * g0.x + b0.x, (bf_hi(raw.x) - st.x) * st.y * g0.y + b0.y);
                  o.y = pk2((bf_lo(raw.y) - st.x) * st.y * g0.z + b0.z, (bf_hi(raw.y) - st.x) * st.y * g0.w + b0.w);
                  o.z = pk2((bf_lo(raw.z) - st.x) * st.y * g1.x + b1.x, (bf_hi(raw.z) - st.x) * st.y * g1.y + b1.y);
                  o.w = pk2((bf_lo(raw.w) - st.x) * st.y * g1.z + b1.z, (bf_hi(raw.w) - st.x) * st.y * g1.w + b1.w);
                  *(LAS v4u*)(vimg + ((chunk >> 2) * 8 + (row >> 4)) * 1024 + (row & 15) * 64 + (chunk & 3) * 16) = o; } }
            __syncthreads();
            { f32x16 acc0 = {}, acc1 = {};
              const bf16* Wh = T_WSB + (size_t)h * 16384 + (32 * wp + r32) * 128 + 8 * hi;
#pragma unroll
              for (int s = 0; s < 8; ++s) {
                  const bf16x8 a = *(const GAS bf16x8*)(Wh + 16 * s);
                  const LAS unsigned char* p0 = vimg + ((wd * 2 + 0) * 8 + s) * 1024 + vp_nat; const LAS unsigned char* p1 = vimg + ((wd * 2 + 1) * 8 + s) * 1024 + vp_nat;
                  const s16x4 l0 = vtr(p0), h0 = vtr(p0 + 256), l1 = vtr(p1), h1 = vtr(p1 + 256);
                  acc0 = __builtin_amdgcn_mfma_f32_32x32x16_bf16(a, (bf16x8){l0[0], l0[1], l0[2], l0[3], h0[0], h0[1], h0[2], h0[3]}, acc0, 0, 0, 0);
                  acc1 = __builtin_amdgcn_mfma_f32_32x32x16_bf16(a, (bf16x8){l1[0], l1[1], l1[2], l1[3], h1[0], h1[1], h1[2], h1[3]}, acc1, 0, 0, 0); }
#pragma unroll
              for (int r = 0; r < 16; ++r) { const int p = 32 * wp + crow(r, hi); const float bs = T_ABS[h * 128 + p];
                  sg[p * SGS + (wd * 2 + 0) * 32 + r32] = acc0[r] + bs; sg[p * SGS + (wd * 2 + 1) * 32 + r32] = acc1[r] + bs; } }
            __syncthreads();
#pragma unroll
            for (int i = 0; i < 4; ++i) { const int row = (tid >> 4) + 32 * i;
                GAS v4u* up = (GAS v4u*)(T_UG + (size_t)(tok0 + row) * AW + cb + chunk * 8); const v4u raw = *up;
                const f32x4 s0 = *(const LAS f32x4*)(sg + row * SGS + chunk * 8), s1 = *(const LAS f32x4*)(sg + row * SGS + chunk * 8 + 4);
                v4u o; o.x = pk2(bf_lo(raw.x) * s0.x, bf_hi(raw.x) * s0.y); o.y = pk2(bf_lo(raw.y) * s0.z, bf_hi(raw.y) * s0.w);
                o.z = pk2(bf_lo(raw.z) * s1.x, bf_hi(raw.z) * s1.y); o.w = pk2(bf_lo(raw.w) * s1.z, bf_hi(raw.w) * s1.w);
                *up = o; }
        }
        __syncthreads();
    }
}

__device__ __forceinline__ void rowpass1(Frame& F, const Args& A) {
    const int gw = F.vcu * NWAVES + F.wave, NGW = F.G * NWAVES, lane = F.lane;
    f32x4 gp[4];
#pragma unroll
    for (int j = 0; j < 4; ++j) gp[j] = ((const GAS f32x4*)T_NPOST)[lane + 64 * j];
    for (int m = gw; m < M; m += NGW) {
        GAS f32x4* orow = (GAS f32x4*)(T_OUT + (size_t)m * DM) + lane; const GAS f32x4* xr = (const GAS f32x4*)(T_X + (size_t)m * DM) + lane;
        f32x4 v[4], xv[4]; float s = 0.f;
#pragma unroll
        for (int j = 0; j < 4; ++j) { v[j] = orow[64 * j]; xv[j] = xr[64 * j]; s += (v[j].x * v[j].x + v[j].y * v[j].y) + (v[j].z * v[j].z + v[j].w * v[j].w); }
        const float rstd = 1.0f / sqrtf(wave_sum(s) * (1.f / DM) + EPS); float s1 = 0.f;
#pragma unroll
        for (int j = 0; j < 4; ++j) { v[j] = xv[j] + v[j] * rstd * gp[j]; orow[64 * j] = v[j]; s1 += (v[j].x * v[j].x + v[j].y * v[j].y) + (v[j].z * v[j].z + v[j].w * v[j].w); }
        const float rstd1 = 1.0f / sqrtf(wave_sum(s1) * (1.f / DM) + EPS);
        GAS v2u* o8 = (GAS v2u*)(T_XB + (size_t)m * DM) + lane;
#pragma unroll
        for (int j = 0; j < 4; ++j) { v2u w; w.x = pk2(v[j].x * rstd1, v[j].y * rstd1); w.y = pk2(v[j].z * rstd1, v[j].w * rstd1); o8[64 * j] = w; }
    }
}
__device__ __forceinline__ void rowpass2(Frame& F, const Args& A) {
    const int gw = F.vcu * NWAVES + F.wave, NGW = F.G * NWAVES, lane = F.lane;
    f32x4 gp[4];
#pragma unroll
    for (int j = 0; j < 4; ++j) gp[j] = ((const GAS f32x4*)(T_NPOST + DM))[lane + 64 * j];
    for (int m = gw; m < M; m += NGW) {
        GAS f32x4* orow = (GAS f32x4*)(T_OUT + (size_t)m * DM) + lane; const GAS f32x4* yr = (const GAS f32x4*)(T_OUT2 + (size_t)m * DM) + lane;
        f32x4 v[4], xv[4]; float s = 0.f;
#pragma unroll
        for (int j = 0; j < 4; ++j) { v[j] = yr[64 * j]; xv[j] = orow[64 * j]; s += (v[j].x * v[j].x + v[j].y * v[j].y) + (v[j].z * v[j].z + v[j].w * v[j].w); }
        const float rstd = 1.0f / sqrtf(wave_sum(s) * (1.f / DM) + EPS);
#pragma unroll
        for (int j = 0; j < 4; ++j) orow[64 * j] = xv[j] + v[j] * rstd * gp[j];
    }
}

__device__ __forceinline__ int t5_bucket(int rel) {
    const int n = rel < 0 ? -rel : rel; int ret = rel > 0 ? 16 : 0;
    if (n < 8) return ret + n;
    int large = 8 + (int)(logf((float)n / 8.0f) / 4.852030263919617f * 8.0f);
    large = large < 15 ? large : 15;
    return ret + large;
}
__device__ __forceinline__ unsigned cvtpk_s(float lo, float hi) { typedef __bf16 bf16x2_t __attribute__((ext_vector_type(2))); f32x2 v = {lo, hi}; bf16x2_t b = __builtin_convertvector(v, bf16x2_t); return __builtin_bit_cast(unsigned, b); }
__device__ __forceinline__ void attn_phase(Frame& F, const Args& A, int b) {
    constexpr int K_OFF = 0, V_OFF = 49152, LUT_OFF = 98304, SCR_OFF = 102400, STG_OFF = 104448;
    static_assert(STG_OFF + 8 * 4096 <= RING_BYTES, "attention LDS map");
    const int tid = F.tid, lane = F.lane, wave = F.wave, r32 = lane & 31, hi = lane >> 5;
    LAS unsigned char* lds = F.lds;
    LAS float* lut = (LAS float*)(lds + LUT_OFF);
    LAS float* wsf = (LAS float*)(lds + SCR_OFF) + wave * 64;
    LAS bf16* stg = (LAS bf16*)(lds + STG_OFF + wave * 4096);
    float* LSEb = T_LSE + (size_t)b * SEQ * 48;
    for (int it = F.vcu; it < 1536; it += F.G) {
        const int hg = it >> 5, sub = it & 31, h = hg / 3, g = hg % 3;
        int d, r, qb;
        if (g == 0) { d = 1; r = 0; qb = sub; } else if (g == 1) { d = 4; r = sub >> 3; qb = sub & 7; } else { d = 16; r = sub >> 1; qb = sub & 1; }
        const int L = SEQ / d, lq0 = qb * 256, lk0 = lq0 - 64;
        const size_t lstride = (size_t)d * NQKVG;
        bf16* base = T_QKVG + (size_t)r * NQKVG + g * 3072 + h * 64;
#pragma unroll
        for (int rg = 0; rg < 6; ++rg) { int l = lk0 + 64 * rg + lane; l = l < 0 ? 0 : (l > L - 1 ? L - 1 : l);
            __builtin_amdgcn_global_load_lds((const unsigned*)(base + 1024 + (size_t)l * lstride + wave * 8), (LAS unsigned*)(lds + K_OFF + wave * 6144 + rg * 1024), 16, 0, 0); }
#pragma unroll
        for (int i = 0; i < 6; ++i) { const int pi = wave * 6 + i, dh = pi / 24, G = pi % 24; int l = lk0 + 16 * G + (lane >> 2); l = l < 0 ? 0 : (l > L - 1 ? L - 1 : l);
            __builtin_amdgcn_global_load_lds((const unsigned*)(base + 2048 + (size_t)l * lstride + dh * 32 + (lane & 3) * 8), (LAS unsigned*)(lds + V_OFF + pi * 1024), 16, 0, 0); }
        for (int idx = tid; idx < 1024; idx += NWAVES * 64) { const int c = idx >> 8, i = idx & 255, rel = i - c - 96; float v = -1e30f;
            if (rel >= -64 && rel <= 64) v = T_RELB[t5_bucket(rel * d) * 48 + g * 16 + h] * LOG2E;
            lut[idx] = v; }
        bf16* qrow = base + (size_t)(lq0 + 32 * wave + r32) * lstride;
        bf16x8 qr[4];
#pragma unroll
        for (int d0 = 0; d0 < 4; ++d0) qr[d0] = *(const GAS bf16x8*)(qrow + d0 * 16 + hi * 8);
        __syncthreads();
        f32x16 S[5];
        { const int c = r32 & 3; const LAS float* lp = lut + c * 256 + (32 - (r32 - c)) + 4 * hi;
#pragma unroll
          for (int j = 0; j < 5; ++j)
#pragma unroll
              for (int a = 0; a < 4; ++a) { const f32x4 v = *(const LAS f32x4*)(lp + 32 * j + 8 * a); S[j][4 * a] = v.x; S[j][4 * a + 1] = v.y; S[j][4 * a + 2] = v.z; S[j][4 * a + 3] = v.w; } }
#pragma unroll
        for (int j = 0; j < 5; ++j)
#pragma unroll
            for (int d0 = 0; d0 < 4; ++d0) { const bf16x8 kf = *(const LAS bf16x8*)(lds + K_OFF + (2 * d0 + hi) * 6144 + (32 * (wave + j) + r32) * 16);
                S[j] = __builtin_amdgcn_mfma_f32_32x32x16_bf16(kf, qr[d0], S[j], 0, 0, 0); }
        { const int kb = lk0 + 32 * wave;
          if (kb < 0 || kb + 160 > L) {
#pragma unroll
              for (int j = 0; j < 5; ++j)
#pragma unroll
                  for (int rr = 0; rr < 16; ++rr) { const int l = kb + 32 * j + crow(rr, hi); if (l < 0 || l >= L) S[j][rr] = -1e30f; } } }
        float mx = S[0][0];
#pragma unroll
        for (int j = 0; j < 5; ++j)
#pragma unroll
            for (int rr = 0; rr < 16; ++rr) mx = fmaxf(mx, S[j][rr]);
        { auto sw = __builtin_amdgcn_permlane32_swap(__float_as_uint(mx), __float_as_uint(mx), false, false); mx = fmaxf(__uint_as_float(sw[0]), __uint_as_float(sw[1])); }
        float lsum = 0.f;
#pragma unroll
        for (int j = 0; j < 5; ++j)
#pragma unroll
            for (int rr = 0; rr < 16; ++rr) { const float p = __builtin_amdgcn_exp2f(S[j][rr] - mx); S[j][rr] = p; lsum += p; }
        { auto sw = __builtin_amdgcn_permlane32_swap(__float_as_uint(lsum), __float_as_uint(lsum), false, false); lsum = __uint_as_float(sw[0]) + __uint_as_float(sw[1]); }
        f32x16 o0 = {}, o1 = {};
        { const LAS unsigned char* vp0 = lds + V_OFF + ((lane >> 4) & 1) * 32 + (lane & 3) * 8 + (4 * hi + ((lane & 15) >> 2)) * 64;
#pragma unroll
          for (int j = 0; j < 5; ++j)
#pragma unroll
              for (int s = 0; s < 2; ++s) {
                  v4u pw; pw.x = cvtpk_s(S[j][8 * s], S[j][8 * s + 1]); pw.y = cvtpk_s(S[j][8 * s + 2], S[j][8 * s + 3]); pw.z = cvtpk_s(S[j][8 * s + 4], S[j][8 * s + 5]); pw.w = cvtpk_s(S[j][8 * s + 6], S[j][8 * s + 7]);
                  const bf16x8 pa = __builtin_bit_cast(bf16x8, pw);
                  const int G = 2 * (wave + j) + s;
                  const LAS unsigned char* a0 = vp0 + G * 1024; const LAS unsigned char* a1 = vp0 + (24 + G) * 1024;
                  const s16x4 l0 = vtr(a0), h0 = vtr(a0 + 512), l1 = vtr(a1), h1 = vtr(a1 + 512);
                  o0 = __builtin_amdgcn_mfma_f32_32x32x16_bf16(pa, (bf16x8){l0[0], l0[1], l0[2], l0[3], h0[0], h0[1], h0[2], h0[3]}, o0, 0, 0, 0);
                  o1 = __builtin_amdgcn_mfma_f32_32x32x16_bf16(pa, (bf16x8){l1[0], l1[1], l1[2], l1[3], h1[0], h1[1], h1[2], h1[3]}, o1, 0, 0, 0); } }
        if (hi == 0) wsf[r32] = lsum;
        LDS_WAIT();
#pragma unroll
        for (int rr = 0; rr < 16; ++rr) { const int orow = crow(rr, hi); const float rl = __builtin_amdgcn_rcpf(wsf[orow]);
            stg[orow * 64 + r32] = (bf16)f2bf(o0[rr] * rl); stg[orow * 64 + 32 + r32] = (bf16)f2bf(o1[rr] * rl); }
        LDS_WAIT();
#pragma unroll
        for (int i = 0; i < 4; ++i) { const int row = i * 8 + (lane >> 3), ch = lane & 7; const v4u v = *(const LAS v4u*)(stg + row * 64 + ch * 8);
            *(GAS v4u*)(base + (size_t)(lq0 + 32 * wave + row) * lstride + ch * 8) = v; }
        if (hi == 0) LSEb[(size_t)((lq0 + 32 * wave + r32) * d + r) * 48 + g * 16 + h] = mx + __builtin_amdgcn_logf(lsum);
        __syncthreads();
    }
}
__device__ __forceinline__ void merge_phase(Frame& F, const Args& A, int b) {
    const float* LSEb = T_LSE + (size_t)b * SEQ * 48; bf16* Y = T_XB + (size_t)b * SEQ * DM;
    for (int e = F.vcu * NWAVES * 64 + F.tid; e < SEQ * 128; e += F.G * NWAVES * 64) {
        const int t = e >> 7, hc = e & 127, h = hc >> 3, ch = hc & 7;
        const float l0 = LSEb[(size_t)t * 48 + h], l1 = LSEb[(size_t)t * 48 + 16 + h], l2 = LSEb[(size_t)t * 48 + 32 + h];
        const float mm = fmaxf(l0, fmaxf(l1, l2));
        float w0 = __builtin_amdgcn_exp2f(l0 - mm), w1 = __builtin_amdgcn_exp2f(l1 - mm), w2 = __builtin_amdgcn_exp2f(l2 - mm);
        const float inv = 1.0f / (w0 + w1 + w2); w0 *= inv; w1 *= inv; w2 *= inv;
        const bf16* rowp = T_QKVG + (size_t)t * NQKVG + h * 64 + ch * 8;
        const v4u a = *(const GAS v4u*)rowp, bq = *(const GAS v4u*)(rowp + 3072), c = *(const GAS v4u*)(rowp + 6144), gt = *(const GAS v4u*)(rowp + 9216);
        v4u o;
#define MRG(f) { const float v0 = w0 * bf_lo(a.f) + w1 * bf_lo(bq.f) + w2 * bf_lo(c.f), v1 = w0 * bf_hi(a.f) + w1 * bf_hi(bq.f) + w2 * bf_hi(c.f); \
                 o.f = pk2(v0 * pg8::silu_f(bf_lo(gt.f)), v1 * pg8::silu_f(bf_hi(gt.f))); }
        MRG(x) MRG(y) MRG(z) MRG(w)
#undef MRG
        *(GAS v4u*)(Y + (size_t)t * DM + h * 64 + ch * 8) = o;
    }
}

__global__ void __launch_bounds__(NWAVES * 64, 2) fwd_kernel(Args args) {
    extern __shared__ __attribute__((aligned(16))) unsigned char lds_raw[];
    Frame F;
    F.lds = (LAS unsigned char*)lds_raw;
    volatile LAS unsigned* MISC = (volatile LAS unsigned*)(F.lds + MISC_OFF);
    F.tid = threadIdx.x; F.lane = F.tid & 63; F.wave = __builtin_amdgcn_readfirstlane(F.tid >> 6);
    F.G = gridDim.x; { const int bx = blockIdx.x; F.vcu = (F.G % 8 == 0) ? (bx % 8) * (F.G / 8) + bx / 8 : bx; }
    const Args& A = args; unsigned char* ws = args.ws;
    for (int u = F.tid; u < (LDS_BYTES - LDSCTL_OFF) / 4; u += NWAVES * 64) ((LAS unsigned*)(F.lds + LDSCTL_OFF))[u] = 0u;
    __syncthreads();
    XcdBarrier bar; bar.bar = (unsigned*)(ws + WS_CTL) + CW_BAR; bar.x = 0; bar.st = nullptr;
    const int lo = args.ph_lo, hi = args.ph_hi;
    if (hi - lo > 1) bar = xcd_barrier_post((unsigned*)(ws + WS_CTL) + CW_BAR, MISC + 8);
#define IN(k) (lo <= (k) && (k) < hi)
#define SEAM(k) do { if (IN(k) && IN((k) + 1)) xcd_barrier(bar); } while (0)

    if (IN(0)) { p0_prologue(F, args); SEAM(0); }
    if (IN(1)) {
        pg8::Gemm g{T_XB, T_WA1, M, 3 * AW, DM}; pg8::StaticOrder S; S.init(M, 3 * AW, F.G, (int)blockIdx.x);
        pg8::EpiA1 E{T_UG, T_GV, T_VST};
        pg8::gemm_phase<pg8::EpiA1, pg8::StaticOrder, true, true>(F.lds, g, S, E);
        SEAM(1); }
    if (IN(2)) { spatial_phase(F, args); SEAM(2); }
    if (IN(3)) {
        pg8::Gemm g{T_UG, T_WA2, M, DM, AW}; pg8::StaticOrder S; S.init(M, DM, F.G, (int)blockIdx.x);
        pg8::EpiF32 E{T_OUT, DM};
        pg8::gemm_phase<pg8::EpiF32, pg8::StaticOrder, true, true>(F.lds, g, S, E);
        SEAM(3); }
    if (IN(4)) { rowpass1(F, args); SEAM(4); }
#define LAYER1_BATCH(b, p) \
    if (IN(p)) { \
        pg8::Gemm g{T_XB + (size_t)(b) * SEQ * DM, T_WB1, SEQ, NQKVG, DM}; pg8::StaticOrder S; S.init(SEQ, NQKVG, F.G, (int)blockIdx.x); \
        pg8::EpiBf16 E{T_QKVG, NQKVG}; \
        pg8::gemm_phase<pg8::EpiBf16, pg8::StaticOrder, true, true>(F.lds, g, S, E); \
        SEAM(p); } \
    if (IN((p) + 1)) { attn_phase(F, args, b); SEAM((p) + 1); } \
    if (IN((p) + 2)) { merge_phase(F, args, b); SEAM((p) + 2); }
    LAYER1_BATCH(0, 5)
    LAYER1_BATCH(1, 8)
#undef LAYER1_BATCH
    if (IN(11)) {
        pg8::Gemm g{T_XB, T_WB2, M, DM, DM}; pg8::StaticOrder S; S.init(M, DM, F.G, (int)blockIdx.x);
        pg8::EpiF32 E{T_OUT2, DM};
        pg8::gemm_phase<pg8::EpiF32, pg8::StaticOrder, true, true>(F.lds, g, S, E);
        SEAM(11); }
    if (IN(12)) { rowpass2(F, args); }
#undef IN
#undef SEAM
}

extern "C" void kernel_launch(void* const* d_in, const int* in_sizes, int n_in, void* d_out, int out_size, void* d_ws, size_t ws_size, hipStream_t stream) {
    static int grid = 0;
    if (grid == 0) {
        if (n_in != 12 || in_sizes[0] != M * DM || out_size != M * DM || ws_size < WS_END) { fprintf(stderr, "kernel_launch: unexpected shapes (n_in %d, in0 %d, out %d, ws %zu); nothing launched\n", n_in, n_in > 0 ? in_sizes[0] : -1, out_size, ws_size); grid = -1; return; }
        int dev = 0, cus = 0;
        if (hipGetDevice(&dev) != hipSuccess || hipDeviceGetAttribute(&cus, hipDeviceAttributeMultiprocessorCount, dev) != hipSuccess) { grid = -1; return; }
        if (hipFuncSetAttribute((const void*)fwd_kernel, hipFuncAttributeMaxDynamicSharedMemorySize, LDS_BYTES) != hipSuccess) { fprintf(stderr, "kernel_launch: hipFuncSetAttribute failed\n"); grid = -1; return; }
        int per_cu = 0;
        if (hipOccupancyMaxActiveBlocksPerMultiprocessor(&per_cu, (const void*)fwd_kernel, NWAVES * 64, LDS_BYTES) != hipSuccess || per_cu < 1) fprintf(stderr, "kernel_launch: occupancy query reports %d blocks per CU\n", per_cu);
        (void)hipGetLastError();
        grid = cus;
    }
    if (grid < 0) return;
    if (hipMemsetAsync((char*)d_ws + WS_CTL, 0, CTL_ZERO_BYTES, stream) != hipSuccess) return;
    Args a{};
    for (int i = 0; i < 12; ++i) a.in[i] = (const float*)d_in[i];
    a.out = (float*)d_out; a.ws = (unsigned char*)d_ws;
    if (MK_N_LAUNCHES == 1) { a.ph_lo = 0; a.ph_hi = N_PHASES; hipLaunchKernelGGL(fwd_kernel, dim3(grid), dim3(NWAVES * 64), LDS_BYTES, stream, a); }
    else for (int p = 0; p < N_PHASES; ++p) { a.ph_lo = p; a.ph_hi = p + 1; hipLaunchKernelGGL(fwd_kernel, dim3(grid), dim3(NWAVES * 64), LDS_BYTES, stream, a); }
}
```
